# Optimizing an MI355X kernel written in HIP

```python
import jax, jax.numpy as jnp
from jax import lax
import numpy as np

D_MODEL = 1024
BATCH = 4
SEQ = 4096
DEPTH = 4

N_MIXERS = 2
ALPHA = (2 * DEPTH) ** 0.25
BETA = (8 * DEPTH) ** -0.25
LN_EPS = 1e-5
N_A = (DEPTH + 1) // 2
N_B = DEPTH // 2
D_FF = 2816
ML_HEADS = 4
ML_DQK = D_MODEL // (2 * ML_HEADS)
ML_DV = D_MODEL // ML_HEADS
ML_QK = ML_HEADS * ML_DQK
ML_PROJ = 2 * ML_QK + 2 * D_MODEL + 4 * ML_HEADS
CHUNK = 64
HEAD_DIM = 64
N_Q_HEADS = D_MODEL // HEAD_DIM
N_KV_HEADS = 4
GROUP = N_Q_HEADS // N_KV_HEADS
WINDOW = 128
BLOCK = 128
AT_PROJ = (N_Q_HEADS + 2 * N_KV_HEADS) * HEAD_DIM
MASK_VALUE = -1e30

kernel_name = "hybrid_mlstm_swa_macaron_deepnorm"


def layer_norm(x, g, b):
    xf = x.astype(jnp.float32)
    mu = jnp.mean(xf, axis=-1, keepdims=True)
    var = jnp.mean(jnp.square(xf - mu), axis=-1, keepdims=True)
    return ((xf - mu) * lax.rsqrt(var + LN_EPS) * g + b).astype(x.dtype)


def swiglu(x, w_in, w_out):
    gu = x @ w_in
    g, u = gu[..., :D_FF], gu[..., D_FF:]
    return (jax.nn.silu(g) * u) @ w_out


def mlstm_chunkwise(q, k, v, i_pre, f_pre):
    B, H, S, dk = q.shape
    dv = v.shape[-1]
    nc = S // CHUNK
    q = q.astype(jnp.float32).reshape(B, H, nc, CHUNK, dk)
    k = k.astype(jnp.float32).reshape(B, H, nc, CHUNK, dk)
    v = v.astype(jnp.float32).reshape(B, H, nc, CHUNK, dv)
    logf = jax.nn.log_sigmoid(f_pre.astype(jnp.float32)).reshape(B, H, nc, CHUNK)
    ig = i_pre.astype(jnp.float32).reshape(B, H, nc, CHUNK)
    g = jnp.cumsum(logf, axis=-1)
    G = g[..., -1]
    w_end = G[..., None] - g + ig
    a = jnp.max(w_end, axis=-1)
    e_end = jnp.exp(w_end - a[..., None])
    K_c = jnp.einsum('bhcl,bhclv,bhclk->bhcvk', e_end, v, k)
    N_c = jnp.einsum('bhcl,bhclk->bhck', e_end, k)

    def step(carry, inp):
        C, n, m = carry
        Gc, ac, Kc, Nc = inp
        m_new = jnp.maximum(Gc + m, ac)
        sp = jnp.exp(Gc + m - m_new)
        sc = jnp.exp(ac - m_new)
        C_new = sp[..., None, None] * C + sc[..., None, None] * Kc
        n_new = sp[..., None] * n + sc[..., None] * Nc
        return (C_new, n_new, m_new), (C, n, m)

    init = (jnp.zeros((B, H, dv, dk), jnp.float32), jnp.zeros((B, H, dk), jnp.float32),
            jnp.zeros((B, H), jnp.float32))
    xs = (jnp.moveaxis(G, 2, 0), jnp.moveaxis(a, 2, 0), jnp.moveaxis(K_c, 2, 0), jnp.moveaxis(N_c, 2, 0))
    _, (C0, n0, m0) = lax.scan(step, init, xs)
    C0 = jnp.moveaxis(C0, 0, 2)
    n0 = jnp.moveaxis(n0, 0, 2)
    m0 = jnp.moveaxis(m0, 0, 2)

    tril = jnp.tril(jnp.ones((CHUNK, CHUNK), dtype=bool))
    dmat = g[..., :, None] - g[..., None, :] + ig[..., None, :]
    dmat = jnp.where(tril, dmat, MASK_VALUE)
    inter_log = g + m0[..., None]
    m_out = jnp.maximum(inter_log, jnp.max(dmat, axis=-1))
    wts = jnp.exp(dmat - m_out[..., None])
    s_inter = jnp.exp(inter_log - m_out)
    s_qk = jnp.einsum('bhcjd,bhcsd->bhcjs', q, k) * wts
    num = jnp.einsum('bhcjs,bhcsv->bhcjv', s_qk, v) + s_inter[..., None] * jnp.einsum('bhcvd,bhcjd->bhcjv', C0, q)
    den = jnp.sum(s_qk, axis=-1) + s_inter * jnp.einsum('bhcd,bhcjd->bhcj', n0, q)
    den = jnp.maximum(jnp.abs(den), jnp.exp(-m_out))
    h = num / den[..., None]
    return h.reshape(B, H, S, dv)


def mlstm_mixer(x, w_in, gate_b, norm_g, w_out):
    B, S, _ = x.shape
    p = x @ w_in
    q = p[..., :ML_QK].reshape(B, S, ML_HEADS, ML_DQK).transpose(0, 2, 1, 3)
    k = p[..., ML_QK:2 * ML_QK].reshape(B, S, ML_HEADS, ML_DQK).transpose(0, 2, 1, 3) * (ML_DQK ** -0.5)
    v = p[..., 2 * ML_QK:2 * ML_QK + D_MODEL].reshape(B, S, ML_HEADS, ML_DV).transpose(0, 2, 1, 3)
    o = p[..., 2 * ML_QK + D_MODEL:2 * ML_QK + 2 * D_MODEL]
    gates = (p[..., 2 * ML_QK + 2 * D_MODEL:] + gate_b).reshape(B, S, 4, ML_HEADS).transpose(2, 0, 3, 1)
    h_f = mlstm_chunkwise(q, k, v, gates[0], gates[1])
    flip = lambda a: jnp.flip(a, axis=2)
    h_b = flip(mlstm_chunkwise(flip(q), flip(k), flip(v), flip(gates[2]), flip(gates[3])))
    h = h_f + h_b
    mu = jnp.mean(h, axis=-1, keepdims=True)
    var = jnp.mean(jnp.square(h - mu), axis=-1, keepdims=True)
    h = (h - mu) * lax.rsqrt(var + LN_EPS)
    h = h.transpose(0, 2, 1, 3).reshape(B, S, D_MODEL) * norm_g
    out = jax.nn.sigmoid(o.astype(jnp.float32)) * h
    return out.astype(x.dtype) @ w_out


def alibi_slopes():
    return jnp.exp2(-8.0 * jnp.arange(1, N_Q_HEADS + 1, dtype=jnp.float32) / N_Q_HEADS)


def window_attention(x, w_in, sink, w_out):
    B, S, _ = x.shape
    nb = S // BLOCK
    p = x @ w_in
    nq = N_Q_HEADS * HEAD_DIM
    nk = N_KV_HEADS * HEAD_DIM
    q = p[..., :nq].reshape(B, nb, BLOCK, N_KV_HEADS, GROUP, HEAD_DIM)
    k = p[..., nq:nq + nk].reshape(B, S, N_KV_HEADS, HEAD_DIM)
    v = p[..., nq + nk:].reshape(B, S, N_KV_HEADS, HEAD_DIM)
    pad = ((0, 0), (BLOCK, BLOCK), (0, 0), (0, 0))
    kp = jnp.pad(k, pad).reshape(B, nb + 2, BLOCK, N_KV_HEADS, HEAD_DIM)
    vp = jnp.pad(v, pad).reshape(B, nb + 2, BLOCK, N_KV_HEADS, HEAD_DIM)
    kw = jnp.concatenate([kp[:, :-2], kp[:, 1:-1], kp[:, 2:]], axis=2)
    vw = jnp.concatenate([vp[:, :-2], vp[:, 1:-1], vp[:, 2:]], axis=2)
    s = jnp.einsum('bnqkgd,bnskd->bnkgqs', q, kw).astype(jnp.float32) * (HEAD_DIM ** -0.5)
    qi = jnp.arange(BLOCK)[:, None]
    kj = jnp.arange(3 * BLOCK)[None, :]
    rel = qi - kj + BLOCK
    dist = jnp.abs(rel).astype(jnp.float32)
    key_pos = jnp.arange(nb)[:, None] * BLOCK - BLOCK + jnp.arange(3 * BLOCK)[None, :]
    valid = (jnp.abs(rel) <= WINDOW)[None] & ((key_pos >= 0) & (key_pos < S))[:, None, :]
    slopes = alibi_slopes().reshape(N_KV_HEADS, GROUP)
    s = s - slopes[:, :, None, None] * dist
    s = jnp.where(valid[None, :, None, None], s, MASK_VALUE)
    sink_l = sink.astype(jnp.float32).reshape(N_KV_HEADS, GROUP)[None, None, :, :, None, None]
    m = jnp.maximum(jnp.max(s, axis=-1, keepdims=True), sink_l)
    pe = jnp.exp(s - m)
    attn = pe / (jnp.sum(pe, axis=-1, keepdims=True) + jnp.exp(sink_l - m))
    o = jnp.einsum('bnkgqs,bnskd->bnqkgd', attn, vw.astype(jnp.float32)).reshape(B, S, nq)
    return o.astype(x.dtype) @ w_out


def setup_inputs(seed: int = 0) -> dict:
    key = jax.random.key(seed)
    ks = jax.random.split(key, 16)
    nrm = jax.random.normal
    x = nrm(ks[0], (BATCH, SEQ, D_MODEL), jnp.float32)
    ffn_w_in = nrm(ks[1], (DEPTH, 2, D_MODEL, 2 * D_FF), jnp.float32) * D_MODEL ** -0.5
    ffn_w_out = nrm(ks[2], (DEPTH, 2, D_FF, D_MODEL), jnp.float32) * (D_FF ** -0.5 * BETA)
    ln_g = 1.0 + 0.02 * nrm(ks[3], (DEPTH, 3, D_MODEL), jnp.float32)
    ln_b = 0.02 * nrm(ks[4], (DEPTH, 3, D_MODEL), jnp.float32)
    ml_w_in = nrm(ks[5], (N_A, D_MODEL, ML_PROJ), jnp.float32) * D_MODEL ** -0.5
    ml_w_in = ml_w_in.at[..., 2 * ML_QK:2 * ML_QK + D_MODEL].multiply(BETA)
    f_off = jnp.linspace(3.0, 6.0, ML_HEADS, dtype=jnp.float32)
    zero = jnp.zeros((ML_HEADS,), jnp.float32)
    gate_off = jnp.stack([zero, f_off, zero, f_off])
    ml_gate_b = (0.1 * nrm(ks[6], (N_A, 4, ML_HEADS), jnp.float32) + gate_off).reshape(N_A, 4 * ML_HEADS)
    ml_norm_g = 1.0 + 0.02 * nrm(ks[7], (N_A, D_MODEL), jnp.float32)
    ml_w_out = nrm(ks[8], (N_A, D_MODEL, D_MODEL), jnp.float32) * (D_MODEL ** -0.5 * BETA)
    at_w_in = nrm(ks[9], (N_B, D_MODEL, AT_PROJ), jnp.float32) * D_MODEL ** -0.5
    at_w_in = at_w_in.at[..., (N_Q_HEADS + N_KV_HEADS) * HEAD_DIM:].multiply(BETA)
    at_sink = 0.5 * nrm(ks[10], (N_B, N_Q_HEADS), jnp.float32)
    at_w_out = nrm(ks[11], (N_B, D_MODEL, D_MODEL), jnp.float32) * (D_MODEL ** -0.5 * BETA)
    return {"x": x, "ffn_w_in": ffn_w_in, "ffn_w_out": ffn_w_out, "ln_g": ln_g, "ln_b": ln_b,
            "ml_w_in": ml_w_in, "ml_gate_b": ml_gate_b, "ml_norm_g": ml_norm_g, "ml_w_out": ml_w_out,
            "at_w_in": at_w_in, "at_sink": at_sink, "at_w_out": at_w_out}


def reference(x, ffn_w_in, ffn_w_out, ln_g, ln_b, ml_w_in, ml_gate_b, ml_norm_g, ml_w_out,
              at_w_in, at_sink, at_w_out):
    for l in range(DEPTH):
        x = layer_norm(ALPHA * x + 0.5 * swiglu(x, ffn_w_in[l, 0], ffn_w_out[l, 0]), ln_g[l, 0], ln_b[l, 0])
        j = l // N_MIXERS
        if l % N_MIXERS == 0:
            y = mlstm_mixer(x, ml_w_in[j], ml_gate_b[j], ml_norm_g[j], ml_w_out[j])
        else:
            y = window_attention(x, at_w_in[j], at_sink[j], at_w_out[j])
        x = layer_norm(ALPHA * x + y, ln_g[l, 1], ln_b[l, 1])
        x = layer_norm(ALPHA * x + 0.5 * swiglu(x, ffn_w_in[l, 1], ffn_w_out[l, 1]), ln_g[l, 2], ln_b[l, 2])
    return x
```

```cpp
#include <hip/hip_runtime.h>
#include <hip/hip_cooperative_groups.h>
#include <cstdio>
#include <cstdint>
namespace cg = cooperative_groups;
namespace pg8 {
#define PG8_LAS __attribute__((address_space(3)))
typedef unsigned short bf16_t;
typedef short bf16x8 __attribute__((ext_vector_type(8)));
typedef float f32x4 __attribute__((ext_vector_type(4)));
typedef unsigned u32x4 __attribute__((ext_vector_type(4)));
constexpr int BM = 256, BK = 64, HALF = 128, HTB = HALF * BK * 2  , STAGE_BYTES = 8 * HTB, NXCD = 8, WGM = 8;

__host__ __device__ __forceinline__ int lds_byte(int r, int c) { const int st = (r >> 4) * 2 + (c >> 5), rr = r & 15, cc = c & 31, ob = rr * 64 + cc * 2; return st * 1024 + (ob ^ (((ob >> 9) & 1) << 5)); }
__host__ __device__ __forceinline__ void stage_rc(int b, int& R, int& C) { const int st = b / 1024, sb = b % 1024, swz = sb ^ (((sb >> 9) & 1) << 5); R = (st >> 1) * 16 + swz / 64; C = (st & 1) * 32 + (swz % 64) / 2; }
__host__ __device__ __forceinline__ int perm32(int rho) { const int n = rho >> 4, i = rho & 15; return 8 * (i >> 2) + 4 * n + (i & 3); }

struct Unit { int pm, pn; };
struct Gemm { const bf16_t* A; const bf16_t* Bt; int M, N, K; };

struct StaticOrder {
    int nM, nN, nwg, G, c;
    __host__ __device__ void init(int M, int N, int G_, int c_) { nM = M / BM; nN = N / BM; nwg = nM * nN; G = G_; c = c_; }
    __host__ __device__ bool next(int i, Unit& u) const {
        const long L = (long)i * G + c; if (L >= nwg) return false;
        int wgid = (int)L; { const int q = nwg / NXCD, r = nwg % NXCD, xcd = wgid % NXCD, off = wgid / NXCD; wgid = (xcd < r ? xcd * (q + 1) : r * (q + 1) + (xcd - r) * q) + off; }
        const int nig = WGM * nN, gid = wgid / nig, fm = gid * WGM, gsz = (nM - fm) < WGM ? (nM - fm) : WGM;
        u.pm = fm + ((wgid % nig) % gsz); u.pn = (wgid % nig) / gsz; return true;
    }
    __device__ __forceinline__ void a_ready(const Unit&) const {}
    __device__ __forceinline__ void done(const Unit&) const {}
};


__device__ __forceinline__ unsigned cvt_pk_bf16(float lo, float hi) { unsigned r; asm volatile("v_cvt_pk_bf16_f32 %0, %1, %2" : "=v"(r) : "v"(lo), "v"(hi)); return r; }
__device__ __forceinline__ float silu_mul(float g, float u) { return g * __builtin_amdgcn_rcpf(1.0f + __builtin_amdgcn_exp2f(-1.4426950408889634f * g)) * u; }

struct EpiPlain {
    static constexpr bool PERM = true, AFTER_DRAIN = false;
    bf16_t* O; int ldc;
    __device__ __forceinline__ void operator()(const f32x4 (&acc)[2][2][4][2], const Unit& u, int wr, int wc, int fr, int fq) const {
        const int row0 = u.pm * BM + wr * 64 + fr; const int col0 = u.pn * BM + wc * 32 + 8 * fq;
#pragma unroll
        for (int ai = 0; ai < 2; ++ai)
#pragma unroll
            for (int m = 0; m < 4; ++m) { bf16_t* rowp = O + (size_t)(row0 + ai * HALF + m * 16) * ldc + col0;
#pragma unroll
                for (int bj = 0; bj < 2; ++bj) { const f32x4 v0 = acc[ai][bj][m][0], v1 = acc[ai][bj][m][1];
                    u32x4 w; w.x = cvt_pk_bf16(v0[0], v0[1]); w.y = cvt_pk_bf16(v0[2], v0[3]); w.z = cvt_pk_bf16(v1[0], v1[1]); w.w = cvt_pk_bf16(v1[2], v1[3]);
                    *(u32x4*)(rowp + bj * HALF) = w; } }
    }
};
struct EpiSwiGLU {
    static constexpr bool PERM = true, AFTER_DRAIN = false;
    bf16_t* H; int ldh;
    __device__ __forceinline__ void operator()(const f32x4 (&acc)[2][2][4][2], const Unit& u, int wr, int wc, int fr, int fq) const {
        const int row0 = u.pm * BM + wr * 64 + fr; const int col0 = u.pn * HALF + wc * 32 + 8 * fq;
#pragma unroll
        for (int ai = 0; ai < 2; ++ai)
#pragma unroll
            for (int m = 0; m < 4; ++m) { bf16_t* rowp = H + (size_t)(row0 + ai * HALF + m * 16) * ldh + col0;
                const f32x4 g0 = acc[ai][0][m][0], g1 = acc[ai][0][m][1], u0 = acc[ai][1][m][0], u1 = acc[ai][1][m][1];
                u32x4 w; w.x = cvt_pk_bf16(silu_mul(g0[0], u0[0]), silu_mul(g0[1], u0[1])); w.y = cvt_pk_bf16(silu_mul(g0[2], u0[2]), silu_mul(g0[3], u0[3]));
                w.z = cvt_pk_bf16(silu_mul(g1[0], u1[0]), silu_mul(g1[1], u1[1])); w.w = cvt_pk_bf16(silu_mul(g1[2], u1[2]), silu_mul(g1[3], u1[3]));
                *(u32x4*)rowp = w; }
    }
};
struct EpiResid {
    static constexpr bool PERM = false, AFTER_DRAIN = false;
    const float* X; float* Y; float alpha, s;
    __device__ __forceinline__ void operator()(const f32x4 (&acc)[2][2][4][2], const Unit& u, int wr, int wc, int fr, int fq) const {
        const int row0 = u.pm * BM + wr * 64 + fr; const int col0 = u.pn * BM + wc * 32 + 4 * fq;
#pragma unroll
        for (int ai = 0; ai < 2; ++ai)
#pragma unroll
            for (int m = 0; m < 4; ++m) { const size_t off = (size_t)(row0 + ai * HALF + m * 16) * 1024 + col0;
#pragma unroll
                for (int bj = 0; bj < 2; ++bj)
#pragma unroll
                    for (int n = 0; n < 2; ++n) { const size_t p = off + bj * HALF + n * 16; const f32x4 x = *(const f32x4*)(X + p);
                        *(f32x4*)(Y + p) = x * alpha + acc[ai][bj][m][n] * s; } }
    }
};

template <class Epi, class Sched, bool ALIGN_EPI = false, bool SP2 = false>
__device__ __forceinline__ void gemm_phase(PG8_LAS unsigned char* lds, const Gemm g, const Sched& S, const Epi& E, const int tid) {
    const int wid = __builtin_amdgcn_readfirstlane(tid >> 6), lane = tid & 63, wr = wid >> 2, wc = wid & 3, fr = lane & 15, fq = lane >> 4;
    const int K = g.K, nt = K / BK;
    unsigned voffA[2], voffB[2];
#pragma unroll
    for (int i = 0; i < 2; ++i) { int R, C; stage_rc(tid * 16 + i * 8192, R, C); const int Rb = Epi::PERM ? ((R & ~31) + perm32(R & 31)) : R;
        voffA[i] = (unsigned)(R * K + C) * 2u; voffB[i] = (unsigned)(Rb * K + C) * 2u; }
    const size_t kstep = (size_t)(BK * 2);
    const size_t hstep = (size_t)HALF * K * 2;
    const size_t tstep = 2 * hstep;
    const unsigned ldsw = (unsigned)wid * 1024u;
    const int aoff = lds_byte(wr * 64 + fr, fq * 8), boff = lds_byte(wc * 32 + fr, fq * 8);
#define PG8_SA(b, h) (((b) * 2 + (h)) * HTB)
#define PG8_SB(b, h) ((4 + (b) * 2 + (h)) * HTB)
#define PG8_STAGE(bufoff, gbase, voff) do { _Pragma("unroll") for (int _i = 0; _i < 2; ++_i) \
        __builtin_amdgcn_global_load_lds((const unsigned*)((const char*)(gbase) + (voff)[_i]), (PG8_LAS unsigned*)(lds + (bufoff) + ldsw + _i * 8192), 16, 0, 0); } while (0)
#define PG8_LDA(dst, b, h) do { _Pragma("unroll") for (int m = 0; m < 4; ++m) _Pragma("unroll") for (int k = 0; k < 2; ++k) dst[m][k] = *(const PG8_LAS bf16x8*)(lds + PG8_SA(b, h) + aoff + m * 2048 + k * 1024); } while (0)
#define PG8_LDB(dst, b, h) do { _Pragma("unroll") for (int n = 0; n < 2; ++n) _Pragma("unroll") for (int k = 0; k < 2; ++k) dst[n][k] = *(const PG8_LAS bf16x8*)(lds + PG8_SB(b, h) + boff + n * 2048 + k * 1024); } while (0)
#define PG8_MMA(ai, bj, At, Bt) do { __builtin_amdgcn_s_setprio(1); _Pragma("unroll") for (int m = 0; m < 4; ++m) _Pragma("unroll") for (int n = 0; n < 2; ++n) _Pragma("unroll") for (int k = 0; k < 2; ++k) \
        acc[ai][bj][m][n] = __builtin_amdgcn_mfma_f32_16x16x32_bf16(Bt[n][k], At[m][k], acc[ai][bj][m][n], 0, 0, 0); __builtin_amdgcn_s_setprio(0); } while (0)
#define PG8_WAIT_V(n) asm volatile("s_waitcnt vmcnt(" #n ")" ::: "memory")
#define PG8_WAIT_L(n) asm volatile("s_waitcnt lgkmcnt(" #n ")" ::: "memory")
#define PG8_BAR __builtin_amdgcn_s_barrier()
#define PG8_SCHED __builtin_amdgcn_sched_barrier(0)
    Unit cur, nxt; int ui = 0;
    if (!S.next(0, cur)) return;
    f32x4 acc[2][2][4][2];
#pragma unroll
    for (int a = 0; a < 2; ++a)
#pragma unroll
        for (int b = 0; b < 2; ++b)
#pragma unroll
            for (int m = 0; m < 4; ++m)
#pragma unroll
                for (int n = 0; n < 2; ++n) acc[a][b][m][n] = (f32x4){0.f, 0.f, 0.f, 0.f};
    bf16x8 At[4][2], B0[2][2], B1[2][2];
    const char* cA = (const char*)g.A + (size_t)cur.pm * tstep; const char* cB = (const char*)g.Bt + (size_t)cur.pn * tstep;
    S.a_ready(cur);
    if constexpr (SP2) {
        PG8_STAGE(PG8_SB(0, 0), cB, voffB); PG8_STAGE(PG8_SB(0, 1), cB + hstep, voffB); PG8_STAGE(PG8_SA(0, 0), cA, voffA); PG8_STAGE(PG8_SA(0, 1), cA + hstep, voffA);
        if (wr == 1) PG8_BAR;
        PG8_WAIT_V(2); PG8_BAR;
        PG8_STAGE(PG8_SB(1, 0), cB + kstep, voffB); PG8_STAGE(PG8_SA(1, 0), cA + kstep, voffA); PG8_STAGE(PG8_SB(1, 1), cB + hstep + kstep, voffB);
        PG8_WAIT_V(6); PG8_BAR;
    } else {
        PG8_STAGE(PG8_SB(0, 0), cB, voffB); PG8_STAGE(PG8_SA(0, 0), cA, voffA); PG8_STAGE(PG8_SB(0, 1), cB + hstep, voffB); PG8_STAGE(PG8_SA(0, 1), cA + hstep, voffA);
        if (wr == 1) PG8_BAR;
        PG8_WAIT_V(4); PG8_BAR;
        PG8_STAGE(PG8_SB(1, 0), cB + kstep, voffB); PG8_STAGE(PG8_SA(1, 0), cA + kstep, voffA); PG8_STAGE(PG8_SB(1, 1), cB + hstep + kstep, voffB);
        PG8_WAIT_V(6); PG8_BAR;
    }
    for (;;) {
        const bool has_next = S.next(ui + 1, nxt);
        const char* nA = has_next ? (const char*)g.A + (size_t)nxt.pm * tstep : cA; const char* nB = has_next ? (const char*)g.Bt + (size_t)nxt.pn * tstep : cB;
        for (int t = 0; t < nt; t += 2) {
            const bool last = (t == nt - 2);
            const char* a1 = cA + (size_t)(t + 1) * kstep;
            const char* a2 = last ? nA : cA + (size_t)(t + 2) * kstep; const char* b2 = last ? nB : cB + (size_t)(t + 2) * kstep;
            const char* a3 = a2 + kstep; const char* b3 = b2 + kstep;
            if (last && has_next) S.a_ready(nxt);
            if constexpr (SP2) {
            PG8_LDB(B0, 0, 0); PG8_LDB(B1, 0, 1); PG8_SCHED; PG8_LDA(At, 0, 0); PG8_STAGE(PG8_SA(1, 1), a1 + hstep, voffA);
            PG8_WAIT_V(8); PG8_WAIT_L(0); PG8_BAR; PG8_MMA(0, 0, At, B0); PG8_MMA(0, 1, At, B1); PG8_BAR; PG8_SCHED;
            PG8_LDA(At, 0, 1); PG8_STAGE(PG8_SB(0, 0), b2, voffB); PG8_STAGE(PG8_SB(0, 1), b2 + hstep, voffB); PG8_STAGE(PG8_SA(0, 0), a2, voffA);
            PG8_WAIT_V(8); PG8_WAIT_L(0); PG8_BAR; PG8_MMA(1, 0, At, B0); PG8_MMA(1, 1, At, B1); PG8_BAR; PG8_SCHED;
            PG8_LDB(B0, 1, 0); PG8_LDB(B1, 1, 1); PG8_SCHED; PG8_LDA(At, 1, 0); PG8_STAGE(PG8_SA(0, 1), a2 + hstep, voffA);
            PG8_WAIT_V(8); PG8_WAIT_L(0); PG8_BAR; PG8_MMA(0, 0, At, B0); PG8_MMA(0, 1, At, B1); PG8_BAR; PG8_SCHED;
            PG8_LDA(At, 1, 1); PG8_STAGE(PG8_SB(1, 0), b3, voffB); PG8_STAGE(PG8_SB(1, 1), b3 + hstep, voffB); PG8_STAGE(PG8_SA(1, 0), a3, voffA);
            PG8_WAIT_V(8); PG8_WAIT_L(0); PG8_BAR; PG8_MMA(1, 0, At, B0); PG8_MMA(1, 1, At, B1); PG8_BAR; PG8_SCHED;
            } else {
            PG8_LDB(B0, 0, 0); PG8_SCHED; PG8_LDA(At, 0, 0); PG8_STAGE(PG8_SA(1, 1), a1 + hstep, voffA);
            PG8_WAIT_L(8); PG8_BAR; PG8_WAIT_L(0); PG8_MMA(0, 0, At, B0); PG8_BAR; PG8_SCHED;
            PG8_LDB(B1, 0, 1); PG8_STAGE(PG8_SB(0, 0), b2, voffB);
            PG8_BAR; PG8_WAIT_L(0); PG8_MMA(0, 1, At, B1); PG8_BAR;
            PG8_LDA(At, 0, 1); PG8_STAGE(PG8_SA(0, 0), a2, voffA);
            PG8_BAR; PG8_WAIT_L(0); PG8_MMA(1, 0, At, B0); PG8_BAR; PG8_SCHED;
            PG8_STAGE(PG8_SB(0, 1), b2 + hstep, voffB);
            PG8_WAIT_V(6); PG8_BAR; PG8_MMA(1, 1, At, B1); PG8_BAR;
            PG8_LDB(B0, 1, 0); PG8_SCHED; PG8_LDA(At, 1, 0); PG8_STAGE(PG8_SA(0, 1), a2 + hstep, voffA);
            PG8_WAIT_L(8); PG8_BAR; PG8_WAIT_L(0); PG8_MMA(0, 0, At, B0); PG8_BAR; PG8_SCHED;
            PG8_LDB(B1, 1, 1); PG8_STAGE(PG8_SB(1, 0), b3, voffB);
            PG8_BAR; PG8_WAIT_L(0); PG8_MMA(0, 1, At, B1); PG8_BAR;
            PG8_LDA(At, 1, 1); PG8_STAGE(PG8_SA(1, 0), a3, voffA);
            PG8_BAR; PG8_WAIT_L(0); PG8_MMA(1, 0, At, B0); PG8_BAR; PG8_SCHED;
            PG8_STAGE(PG8_SB(1, 1), b3 + hstep, voffB);
            PG8_WAIT_V(6); PG8_BAR; PG8_MMA(1, 1, At, B1); PG8_BAR;
            }
        }
        if constexpr (ALIGN_EPI) { if (wr == 0) PG8_BAR; }
        if constexpr (!Epi::AFTER_DRAIN) { E(acc, cur, wr, wc, fr, fq); S.done(cur); }
        if (!has_next) break;
#pragma unroll
        for (int a = 0; a < 2; ++a)
#pragma unroll
            for (int b = 0; b < 2; ++b)
#pragma unroll
                for (int m = 0; m < 4; ++m)
#pragma unroll
                    for (int n = 0; n < 2; ++n) acc[a][b][m][n] = (f32x4){0.f, 0.f, 0.f, 0.f};
        cur = nxt; cA = nA; cB = nB; ++ui;
        if constexpr (ALIGN_EPI) { if (wr == 1) PG8_BAR; }
    }
    PG8_WAIT_V(0);
    if constexpr (!ALIGN_EPI) { if (wr == 0) PG8_BAR; }
    PG8_BAR;
    if constexpr (Epi::AFTER_DRAIN) { E.fused(acc, cur, wr, wc, fr, fq, lds, wid, lane); S.done(cur); }
#undef PG8_SA
#undef PG8_SB
#undef PG8_STAGE
#undef PG8_LDA
#undef PG8_LDB
#undef PG8_MMA
#undef PG8_WAIT_V
#undef PG8_WAIT_L
#undef PG8_BAR
#undef PG8_SCHED
}
}

#define LAS __attribute__((address_space(3)))
typedef unsigned short bf16_t;
typedef short bf16x8 __attribute__((ext_vector_type(8)));
typedef short s16x4 __attribute__((ext_vector_type(4)));
typedef float f32x4 __attribute__((ext_vector_type(4)));
typedef unsigned u32x4 __attribute__((ext_vector_type(4)));
typedef unsigned u32x2 __attribute__((ext_vector_type(2)));

constexpr int M_TOK = 16384, DM = 1024, FF = 2816, FF2 = 5632, SEQ = 4096, NBATCH = 4, DEPTH = 4;
constexpr int ML_N = 3088, ML_NG = 3072, AT_N = 1536;
constexpr float ALPHA = 1.681792830507429f, LN_EPS = 1e-5f;
constexpr int NWAVES = 8, NTHREADS = 512;

constexpr size_t SZ_WFIN = (size_t)FF2 * DM * 2, SZ_WFOUT = (size_t)DM * FF * 2, SZ_MLIN = (size_t)ML_N * DM * 2, SZ_SQ = (size_t)DM * DM * 2, SZ_ATIN = (size_t)AT_N * DM * 2;
constexpr size_t WS_CTL = 0;
constexpr size_t WS_WFIN = 65536;
constexpr size_t WS_WFOUT = WS_WFIN + 8 * SZ_WFIN;
constexpr size_t WS_MLIN = WS_WFOUT + 8 * SZ_WFOUT;
constexpr size_t WS_MLOUT = WS_MLIN + 2 * SZ_MLIN;
constexpr size_t WS_ATIN = WS_MLOUT + 2 * SZ_SQ;
constexpr size_t WS_ATOUT = WS_ATIN + 2 * SZ_ATIN;
constexpr size_t WS_Y = WS_ATOUT + 2 * SZ_SQ;
constexpr size_t WS_XB = WS_Y + (size_t)M_TOK * DM * 4;
constexpr size_t WS_H = WS_XB + (size_t)M_TOK * DM * 2;
constexpr size_t WS_P = WS_H + (size_t)M_TOK * FF * 2;
constexpr size_t WS_GATES = WS_P + (size_t)M_TOK * ML_NG * 2;
constexpr size_t WS_HF = WS_GATES + (size_t)M_TOK * 16 * 4;
constexpr size_t WS_HB = WS_HF + (size_t)M_TOK * DM * 4;
constexpr size_t WS_AO = WS_HB + (size_t)M_TOK * DM * 4;
constexpr size_t WS_END = WS_AO + (size_t)M_TOK * DM * 2;

constexpr int LDS_BYTES = 147456;

__device__ __forceinline__ unsigned pk_bf16(float lo, float hi) { unsigned r; asm volatile("v_cvt_pk_bf16_f32 %0, %1, %2" : "=v"(r) : "v"(lo), "v"(hi)); return r; }
__device__ __forceinline__ float bf_lo(unsigned w) { return __uint_as_float(w << 16); }
__device__ __forceinline__ float bf_hi(unsigned w) { return __uint_as_float(w & 0xffff0000u); }
__device__ __forceinline__ float wave_sum(float v) {
#pragma unroll
    for (int o = 1; o < 64; o <<= 1) v += __shfl_xor(v, o);
    return v;
}
__device__ __forceinline__ bf16x8 tr_frag(const LAS bf16_t* p0, const LAS bf16_t* p1) {
    const s16x4 lo = __builtin_amdgcn_ds_read_tr16_b64_v4i16((LAS s16x4*)p0), hi = __builtin_amdgcn_ds_read_tr16_b64_v4i16((LAS s16x4*)p1);
    return (bf16x8){lo[0], lo[1], lo[2], lo[3], hi[0], hi[1], hi[2], hi[3]};
}
__device__ __forceinline__ bf16x8 pack8(const f32x4 a, const f32x4 b) {
    u32x4 w; w.x = pk_bf16(a[0], a[1]); w.y = pk_bf16(a[2], a[3]); w.z = pk_bf16(b[0], b[1]); w.w = pk_bf16(b[2], b[3]);
    return __builtin_bit_cast(bf16x8, w);
}

struct Args { const float* in[12]; float* out; unsigned char* ws; int ph_lo, ph_hi; };
typedef LAS const unsigned long long* PTab;
__device__ __forceinline__ unsigned long long ldp_u(PTab tab, int i) { const unsigned long long v = tab[i]; const unsigned lo = __builtin_amdgcn_readfirstlane((unsigned)v), hi = __builtin_amdgcn_readfirstlane((unsigned)(v >> 32)); return ((unsigned long long)hi << 32) | lo; }
__device__ __forceinline__ const float* ldp_f(PTab tab, int i) { return (const float*)ldp_u(tab, i); }

__device__ __forceinline__ void tr_item(const float* W, int K, int N, bf16_t* WT, int dst_row0, float scale, LAS float* scr, int k0, int n0, int lane) {
    const int nn = n0 + (lane & 31); const bool ok = nn < N;
#pragma unroll 8
    for (int i = 0; i < 32; ++i) { const int kk = 2 * i + (lane >> 5); scr[kk * 33 + (lane & 31)] = ok ? W[(size_t)(k0 + kk) * N + nn] * scale : 0.f; }
    asm volatile("s_waitcnt lgkmcnt(0)" ::: "memory");
    const int c = lane & 7;
#pragma unroll
    for (int j = 0; j < 4; ++j) { const int n = (lane >> 3) + 8 * j; const LAS float* s = scr + (8 * c) * 33 + n;
        u32x4 o; o.x = pk_bf16(s[0 * 33], s[1 * 33]); o.y = pk_bf16(s[2 * 33], s[3 * 33]); o.z = pk_bf16(s[4 * 33], s[5 * 33]); o.w = pk_bf16(s[6 * 33], s[7 * 33]);
        if (n0 + n < N) *(u32x4*)(WT + (size_t)(dst_row0 + n) * K + k0 + 8 * c) = o; }
    asm volatile("s_waitcnt lgkmcnt(0)" ::: "memory");
}
__device__ __forceinline__ void phase_prologue(PTab tab, LAS unsigned char* lds, int wave, int lane, int bid_, int nblk_) {
    LAS float* scr = (LAS float*)(lds + wave * 16384);
    const int gw = bid_ * NWAVES + wave, NGW = nblk_ * NWAVES;
    constexpr int I0 = 16 * 176, I1 = 44 * 32, I2 = 16 * 97, I3 = 16 * 32, I4 = 16 * 48, I5 = 16 * 32;
    constexpr int T0 = 8 * I0, T1 = T0 + 8 * I1, T2 = T1 + 2 * I2, T3 = T2 + 2 * I3, T4 = T3 + 2 * I4, T5 = T4 + 2 * I5;
    unsigned char* ws = (unsigned char*)ldp_u(tab, 13);
    for (int it = gw; it < T5; it += NGW) {
        if (it < T0) { const int mi = it / I0, r = it % I0, kb = r / 176, nb = r % 176, n0 = nb * 32;
            const int dr = n0 < FF ? 256 * (n0 / 128) + (n0 % 128) : 256 * ((n0 - FF) / 128) + 128 + ((n0 - FF) % 128);
            tr_item(ldp_f(tab, 1) + (size_t)mi * DM * FF2, DM, FF2, (bf16_t*)(ws + WS_WFIN + mi * SZ_WFIN), dr, 1.f, scr, kb * 64, n0, lane); }
        else if (it < T1) { const int q = it - T0, mi = q / I1, r = q % I1, kb = r / 32, nb = r % 32;
            tr_item(ldp_f(tab, 2) + (size_t)mi * FF * DM, FF, DM, (bf16_t*)(ws + WS_WFOUT + mi * SZ_WFOUT), nb * 32, 1.f, scr, kb * 64, nb * 32, lane); }
        else if (it < T2) { const int q = it - T1, mi = q / I2, r = q % I2, kb = r / 97, nb = r % 97, n0 = nb * 32;
            const float sc = (n0 >= 512 && n0 < 1024) ? 0.08838834764831845f : 1.f;
            tr_item(ldp_f(tab, 5) + (size_t)mi * DM * ML_N, DM, ML_N, (bf16_t*)(ws + WS_MLIN + mi * SZ_MLIN), n0, sc, scr, kb * 64, n0, lane); }
        else if (it < T3) { const int q = it - T2, mi = q / I3, r = q % I3, kb = r / 32, nb = r % 32;
            tr_item(ldp_f(tab, 8) + (size_t)mi * DM * DM, DM, DM, (bf16_t*)(ws + WS_MLOUT + mi * SZ_SQ), nb * 32, 1.f, scr, kb * 64, nb * 32, lane); }
        else if (it < T4) { const int q = it - T3, mi = q / I4, r = q % I4, kb = r / 48, nb = r % 48, n0 = nb * 32;
            tr_item(ldp_f(tab, 9) + (size_t)mi * DM * AT_N, DM, AT_N, (bf16_t*)(ws + WS_ATIN + mi * SZ_ATIN), n0, n0 < 1024 ? 0.125f : 1.f, scr, kb * 64, n0, lane); }
        else { const int q = it - T4, mi = q / I5, r = q % I5, kb = r / 32, nb = r % 32;
            tr_item(ldp_f(tab, 11) + (size_t)mi * DM * DM, DM, DM, (bf16_t*)(ws + WS_ATOUT + mi * SZ_SQ), nb * 32, 1.f, scr, kb * 64, nb * 32, lane); }
    }
    const float* x = ldp_f(tab, 0); bf16_t* xb = (bf16_t*)(ws + WS_XB);
    for (int m = gw; m < M_TOK; m += NGW) {
        const f32x4* xr = (const f32x4*)(x + (size_t)m * DM) + lane; u32x2* o = (u32x2*)(xb + (size_t)m * DM) + lane;
#pragma unroll
        for (int j = 0; j < 4; ++j) { const f32x4 v = xr[64 * j]; u32x2 w; w.x = pk_bf16(v[0], v[1]); w.y = pk_bf16(v[2], v[3]); o[64 * j] = w; }
    }
}

__device__ __forceinline__ void phase_ln(const float* Y, const float* g, const float* b, float* X, bf16_t* XB, int wave, int lane, int bid_, int nblk_) {
    const int gw = bid_ * NWAVES + wave, NGW = nblk_ * NWAVES;
    f32x4 gv[4], bv[4];
#pragma unroll
    for (int j = 0; j < 4; ++j) { gv[j] = ((const f32x4*)g)[lane + 64 * j]; bv[j] = ((const f32x4*)b)[lane + 64 * j]; }
    for (int m = gw; m < M_TOK; m += NGW) {
        const f32x4* yr = (const f32x4*)(Y + (size_t)m * DM) + lane;
        f32x4 v[4]; float s = 0.f;
#pragma unroll
        for (int j = 0; j < 4; ++j) { v[j] = yr[64 * j]; s += (v[j][0] + v[j][1]) + (v[j][2] + v[j][3]); }
        const float mean = wave_sum(s) * (1.f / DM); float s2 = 0.f;
#pragma unroll
        for (int j = 0; j < 4; ++j) { v[j] = v[j] - mean; s2 += (v[j][0] * v[j][0] + v[j][1] * v[j][1]) + (v[j][2] * v[j][2] + v[j][3] * v[j][3]); }
        const float rstd = 1.f / sqrtf(wave_sum(s2) * (1.f / DM) + LN_EPS);
        f32x4* xo = (f32x4*)(X + (size_t)m * DM) + lane; u32x2* bo = (u32x2*)(XB + (size_t)m * DM) + lane;
#pragma unroll
        for (int j = 0; j < 4; ++j) { const f32x4 o = v[j] * rstd * gv[j] + bv[j]; xo[64 * j] = o; u32x2 w; w.x = pk_bf16(o[0], o[1]); w.y = pk_bf16(o[2], o[3]); bo[64 * j] = w; }
    }
}

__device__ __forceinline__ void phase_gates(const bf16_t* XB, const bf16_t* Wg, const float* gb, float* GATES, int wave, int lane, int bid_, int nblk_) {
    const int fr = lane & 15, fq = lane >> 4;
    for (int tg = bid_ * NWAVES + wave; tg < M_TOK / 16; tg += nblk_ * NWAVES) {
        const int t0 = tg * 16; f32x4 acc = {0.f, 0.f, 0.f, 0.f};
        const bf16_t* ap = Wg + (size_t)fr * DM + 8 * fq; const bf16_t* bp = XB + (size_t)(t0 + fr) * DM + 8 * fq;
#pragma unroll 8
        for (int ks = 0; ks < 32; ++ks) acc = __builtin_amdgcn_mfma_f32_16x16x32_bf16(*(const bf16x8*)(ap + ks * 32), *(const bf16x8*)(bp + ks * 32), acc, 0, 0, 0);
        const f32x4 bias = *(const f32x4*)(gb + 4 * fq);
        *(f32x4*)(GATES + (size_t)(t0 + fr) * 16 + 4 * fq) = acc + bias;
    }
}

constexpr int ML_QS = 136, ML_VS = 56;
__device__ __forceinline__ void phase_mlstm(LAS unsigned char* lds, const bf16_t* P, const float* GATES, float* HF, float* HB, int tid, int wave, int lane, int bid_, int nblk_) {
    const int fr = lane & 15, fq = lane >> 4;
    LAS float* Bv = (LAS float*)lds; LAS float* Mv = Bv + 4096; LAS float* EW = Mv + 4096; LAS float* EMO = EW + 4096;
    LAS float* GC = EMO + 4096; LAS float* AC = GC + 64; LAS float* M0 = AC + 64; LAS float* MN = M0 + 64; LAS float* SP = MN + 64;
    LAS bf16_t* Qs = (LAS bf16_t*)(lds + 66816); LAS bf16_t* Ks = Qs + 64 * ML_QS; LAS bf16_t* Vs = Ks + 64 * ML_QS; LAS bf16_t* Vw = Vs + 64 * ML_VS; LAS bf16_t* Cb = Vw + 64 * ML_VS;
    for (int item = bid_; item < 256; item += nblk_) {
        const int xcd = item & 7, idx = item >> 3, bh = xcd * 2 + (idx >> 4), dir = (idx >> 3) & 1, vs = idx & 7, b = bh >> 2, h = bh & 3;
        float* HX = dir ? HB : HF;
        const size_t tokbase = (size_t)b * SEQ;
        for (int cc = 0; cc < 8; ++cc) {
            const int c = wave + 8 * cc, p = 64 * c + lane, t = dir ? SEQ - 1 - p : p;
            const float* gp = GATES + (tokbase + t) * 16 + dir * 8 + h;
            const float gi = gp[0], gf = gp[4];
            const float logf = fminf(gf, 0.f) - log1pf(__expf(-fabsf(gf)));
            float g = logf;
#pragma unroll
            for (int d = 1; d < 64; d <<= 1) { const float o = __shfl_up(g, d); if (lane >= d) g += o; }
            const float G = __shfl(g, 63); const float bb = gi - g; float bm = bb;
#pragma unroll
            for (int d = 1; d < 64; d <<= 1) { const float o = __shfl_up(bm, d); if (lane >= d) bm = fmaxf(bm, o); }
            const float a = G + __shfl(bm, 63);
            Bv[p] = bb; Mv[p] = bm; EMO[p] = g; if (lane == 0) { GC[c] = G; AC[c] = a; }
        }
        __syncthreads();
        if (wave == 0) {
            const float Gc = GC[lane], ac = AC[lane]; float m = 0.f, m0v = 0.f, mnv = 0.f, spv = 0.f;
            for (int c = 0; c < 64; ++c) { const float g_ = __shfl(Gc, c), a_ = __shfl(ac, c); const float mn = fmaxf(g_ + m, a_);
                if (lane == c) { m0v = m; mnv = mn; spv = __expf(g_ + m - mn); } m = mn; }
            M0[lane] = m0v; MN[lane] = mnv; SP[lane] = spv;
        }
        __syncthreads();
        for (int cc = 0; cc < 8; ++cc) {
            const int c = wave + 8 * cc, p = 64 * c + lane;
            const float Mx = fmaxf(M0[c], Mv[p]), g = EMO[p];
            Mv[p] = Mx; EMO[p] = __expf(-g - Mx); EW[p] = __expf(GC[c] + Bv[p] - MN[c]);
        }
        for (int i = tid; i < 64 * 16; i += NTHREADS) { const int l = i >> 4, cix = 32 + (i & 15); Vs[l * ML_VS + cix] = (cix == 32) ? (bf16_t)0x3F80 : (bf16_t)0; Vw[l * ML_VS + cix] = 0; }
        for (int i = tid; i < 48 * ML_QS / 2; i += NTHREADS) ((LAS unsigned*)Cb)[i] = 0u;
        __syncthreads();
        const int qrow0 = tid >> 4, qcp = tid & 15, vrow = tid >> 2, vcp = tid & 3;
        u32x4 rq[2], rk[2], rv;
#define ML_GLOAD(cN) do { _Pragma("unroll") for (int i_ = 0; i_ < 2; ++i_) { const int p_ = 64 * (cN) + qrow0 + 32 * i_, t_ = dir ? SEQ - 1 - p_ : p_; \
                const bf16_t* src_ = P + (tokbase + t_) * ML_NG + h * 128 + qcp * 8; rq[i_] = *(const u32x4*)src_; rk[i_] = *(const u32x4*)(src_ + 512); } \
            if (tid < 256) { const int p_ = 64 * (cN) + vrow, t_ = dir ? SEQ - 1 - p_ : p_; rv = *(const u32x4*)(P + (tokbase + t_) * ML_NG + 1024 + h * 256 + vs * 32 + vcp * 8); } } while (0)
        ML_GLOAD(0);
        f32x4 C[2][3];
#pragma unroll
        for (int i = 0; i < 2; ++i)
#pragma unroll
            for (int j = 0; j < 3; ++j) C[i][j] = (f32x4){0.f, 0.f, 0.f, 0.f};
        for (int c = 0; c < 64; ++c) {
            const int p0 = 64 * c;
#pragma unroll
            for (int i = 0; i < 2; ++i) { const int row = qrow0 + 32 * i; *(LAS u32x4*)(Qs + row * ML_QS + qcp * 8) = rq[i]; *(LAS u32x4*)(Ks + row * ML_QS + qcp * 8) = rk[i]; }
            if (tid < 256) { *(LAS u32x4*)(Vs + vrow * ML_VS + vcp * 8) = rv; const float ew = EW[p0 + vrow];
                u32x4 w; w.x = pk_bf16(bf_lo(rv.x) * ew, bf_hi(rv.x) * ew); w.y = pk_bf16(bf_lo(rv.y) * ew, bf_hi(rv.y) * ew); w.z = pk_bf16(bf_lo(rv.z) * ew, bf_hi(rv.z) * ew); w.w = pk_bf16(bf_lo(rv.w) * ew, bf_hi(rv.w) * ew);
                *(LAS u32x4*)(Vw + vrow * ML_VS + vcp * 8) = w; }
            else if (tid < 320) { const int l = tid - 256; Vw[l * ML_VS + 32] = (bf16_t)(pk_bf16(EW[p0 + l], 0.f) & 0xffffu); }
            __syncthreads();
            if (c + 1 < 64) ML_GLOAD(c + 1);
            const LAS bf16_t* Ccur = Cb + (c & 1) * (48 * ML_QS); LAS bf16_t* Cnxt = Cb + ((c + 1) & 1) * (48 * ML_QS);
            if (wave < 4) {
                const int j0 = 16 * wave, jr = j0 + fr;
                bf16x8 qf[4];
#pragma unroll
                for (int ks = 0; ks < 4; ++ks) qf[ks] = *(const LAS bf16x8*)(Qs + jr * ML_QS + ks * 32 + 8 * fq);
                f32x4 s[4];
#pragma unroll
                for (int st = 0; st < 4; ++st) { s[st] = (f32x4){0.f, 0.f, 0.f, 0.f};
#pragma unroll
                    for (int ks = 0; ks < 4; ++ks) s[st] = __builtin_amdgcn_mfma_f32_16x16x32_bf16(*(const LAS bf16x8*)(Ks + (16 * st + fr) * ML_QS + ks * 32 + 8 * fq), qf[ks], s[st], 0, 0, 0); }
                const float Mj = Mv[p0 + jr];
#pragma unroll
                for (int st = 0; st < 4; ++st) { const f32x4 bvv = *(const LAS f32x4*)(Bv + p0 + 16 * st + 4 * fq);
#pragma unroll
                    for (int i = 0; i < 4; ++i) { const int sidx = 16 * st + 4 * fq + i; const float w = (sidx <= jr) ? __expf(bvv[i] - Mj) : 0.f; s[st][i] *= w; } }
                bf16x8 pf[2]; pf[0] = pack8(s[0], s[1]); pf[1] = pack8(s[2], s[3]);
                f32x4 o[3], it[3];
#pragma unroll
                for (int vt = 0; vt < 3; ++vt) { o[vt] = (f32x4){0.f, 0.f, 0.f, 0.f}; it[vt] = (f32x4){0.f, 0.f, 0.f, 0.f};
#pragma unroll
                    for (int ks = 0; ks < 4; ++ks) it[vt] = __builtin_amdgcn_mfma_f32_16x16x32_bf16(*(const LAS bf16x8*)(Ccur + (16 * vt + fr) * ML_QS + ks * 32 + 8 * fq), qf[ks], it[vt], 0, 0, 0);
#pragma unroll
                    for (int pr = 0; pr < 2; ++pr) { const LAS bf16_t* vp = Vs + (32 * pr + 4 * fq + (fr >> 2)) * ML_VS + 16 * vt + 4 * (fr & 3);
                        o[vt] = __builtin_amdgcn_mfma_f32_16x16x32_bf16(tr_frag(vp, vp + 16 * ML_VS), pf[pr], o[vt], 0, 0, 0); } }
                const float si = __expf(M0[c] - Mj);
#pragma unroll
                for (int vt = 0; vt < 3; ++vt) o[vt] = o[vt] + it[vt] * si;
                float den = __shfl(o[2][0], fr);
                den = fmaxf(fabsf(den), EMO[p0 + jr]);
                const float inv = 1.0f / den;
                const int pj = p0 + jr, t = dir ? SEQ - 1 - pj : pj;
                float* hp = HX + (tokbase + t) * DM + h * 256 + vs * 32 + 4 * fq;
                *(f32x4*)hp = o[0] * inv; *(f32x4*)(hp + 16) = o[1] * inv;
            } else {
                const int sw = wave - 4; const float sp = SP[c];
#pragma unroll
                for (int i = 0; i < 2; ++i)
#pragma unroll
                    for (int j = 0; j < 3; ++j) C[i][j] = C[i][j] * sp;
#pragma unroll
                for (int ks = 0; ks < 2; ++ks) {
                    const int r = 32 * ks + 8 * fq + (fr >> 2);
                    bf16x8 kf[2];
#pragma unroll
                    for (int d2 = 0; d2 < 2; ++d2) { const LAS bf16_t* kp = Ks + r * ML_QS + 16 * (2 * sw + d2) + 4 * (fr & 3); kf[d2] = tr_frag(kp, kp + 4 * ML_QS); }
#pragma unroll
                    for (int vt = 0; vt < 3; ++vt) { const LAS bf16_t* vp = Vw + r * ML_VS + 16 * vt + 4 * (fr & 3); const bf16x8 vf = tr_frag(vp, vp + 4 * ML_VS);
#pragma unroll
                        for (int d2 = 0; d2 < 2; ++d2) C[d2][vt] = __builtin_amdgcn_mfma_f32_16x16x32_bf16(kf[d2], vf, C[d2][vt], 0, 0, 0); }
                }
#pragma unroll
                for (int d2 = 0; d2 < 2; ++d2)
#pragma unroll
                    for (int vt = 0; vt < 3; ++vt) { u32x2 w; w.x = pk_bf16(C[d2][vt][0], C[d2][vt][1]); w.y = pk_bf16(C[d2][vt][2], C[d2][vt][3]);
                        *(LAS u32x2*)(Cnxt + (16 * vt + fr) * ML_QS + 16 * (2 * sw + d2) + 4 * fq) = w; }
            }
            __syncthreads();
        }
    }
}

__device__ __forceinline__ void phase_headnorm(const float* HF, const float* HB, const bf16_t* P, const float* ng, bf16_t* AO, int wave, int lane, int bid_, int nblk_) {
    const int gw = bid_ * NWAVES + wave, NGW = nblk_ * NWAVES;
    for (int it = gw; it < M_TOK * 4; it += NGW) {
        const int t = it >> 2, hh = it & 3; const size_t off = (size_t)t * DM + hh * 256 + 4 * lane;
        const f32x4 v = *(const f32x4*)(HF + off) + *(const f32x4*)(HB + off);
        const float mean = wave_sum((v[0] + v[1]) + (v[2] + v[3])) * (1.f / 256.f);
        const f32x4 d = v - mean;
        const float rstd = 1.f / sqrtf(wave_sum((d[0] * d[0] + d[1] * d[1]) + (d[2] * d[2] + d[3] * d[3])) * (1.f / 256.f) + LN_EPS);
        const f32x4 g = *(const f32x4*)(ng + hh * 256 + 4 * lane);
        const u32x2 ow = *(const u32x2*)(P + (size_t)t * ML_NG + 2048 + hh * 256 + 4 * lane);
        const float o0 = bf_lo(ow.x), o1 = bf_hi(ow.x), o2 = bf_lo(ow.y), o3 = bf_hi(ow.y);
        f32x4 y = d * rstd * g;
        y[0] *= 1.f / (1.f + __expf(-o0)); y[1] *= 1.f / (1.f + __expf(-o1)); y[2] *= 1.f / (1.f + __expf(-o2)); y[3] *= 1.f / (1.f + __expf(-o3));
        u32x2 w; w.x = pk_bf16(y[0], y[1]); w.y = pk_bf16(y[2], y[3]);
        *(u32x2*)(AO + off) = w;
    }
}

constexpr int AT_KS = 72, AT_ROWS = 400;
__device__ __forceinline__ void phase_attn(LAS unsigned char* lds, const bf16_t* P, const float* sinkp, bf16_t* AO, int tid, int wave, int lane, int bid_, int nblk_) {
    const int fr = lane & 15, fq = lane >> 4;
    LAS bf16_t* Ks = (LAS bf16_t*)lds; LAS bf16_t* Vs = Ks + AT_ROWS * AT_KS;
    for (int item = bid_; item < 512; item += nblk_) {
        const int kvh = item & 3, nb = (item >> 2) & 31, b = item >> 7;
        const size_t tokbase = (size_t)b * SEQ;
#pragma unroll
        for (int i = 0; i < 6; ++i) { const int id = tid + NTHREADS * i, row = id >> 3, cp = id & 7, tok = (nb - 1) * 128 + row;
            u32x4 kv = {0u, 0u, 0u, 0u}, vv = {0u, 0u, 0u, 0u};
            if (tok >= 0 && tok < SEQ) { const bf16_t* src = P + (tokbase + tok) * AT_N + 1024 + kvh * 64 + cp * 8; kv = *(const u32x4*)src; vv = *(const u32x4*)(src + 256); }
            *(LAS u32x4*)(Ks + row * AT_KS + cp * 8) = kv; *(LAS u32x4*)(Vs + row * AT_KS + cp * 8) = vv; }
        if (tid < 128) { const int row = 384 + (tid >> 3), cp = tid & 7; const u32x4 z = {0u, 0u, 0u, 0u}; *(LAS u32x4*)(Ks + row * AT_KS + cp * 8) = z; *(LAS u32x4*)(Vs + row * AT_KS + cp * 8) = z; }
        __syncthreads();
        const int g = wave >> 1, rh = wave & 1, hq = kvh * 4 + g;
        const float slope = exp2f(-0.5f * (float)(hq + 1)), sink = sinkp[hq];
        for (int st = 0; st < 4; ++st) {
            const int r0 = 64 * rh + 16 * st;
            const bf16_t* qp = P + (tokbase + nb * 128 + r0 + fr) * AT_N + hq * 64 + 8 * fq;
            const bf16x8 qf0 = *(const bf16x8*)qp, qf1 = *(const bf16x8*)(qp + 32);
            f32x4 s[18];
#pragma unroll
            for (int kt = 0; kt < 18; ++kt) { const LAS bf16_t* kp = Ks + (r0 + 16 * kt + fr) * AT_KS + 8 * fq;
                s[kt] = __builtin_amdgcn_mfma_f32_16x16x32_bf16(*(const LAS bf16x8*)kp, qf0, (f32x4){0.f, 0.f, 0.f, 0.f}, 0, 0, 0);
                s[kt] = __builtin_amdgcn_mfma_f32_16x16x32_bf16(*(const LAS bf16x8*)(kp + 32), qf1, s[kt], 0, 0, 0); }
            const int qpos = 128 + r0 + fr;
            float mx = sink;
#pragma unroll
            for (int kt = 0; kt < 18; ++kt)
#pragma unroll
                for (int i = 0; i < 4; ++i) { const int kj = r0 + 16 * kt + 4 * fq + i; const int rel = qpos - kj, dist = rel < 0 ? -rel : rel, kpos = (nb - 1) * 128 + kj;
                    const bool valid = dist <= 128 && kpos >= 0 && kpos < SEQ;
                    const float sv = valid ? s[kt][i] - slope * (float)dist : -1e30f; s[kt][i] = sv; mx = fmaxf(mx, sv); }
            mx = fmaxf(mx, __shfl_xor(mx, 16)); mx = fmaxf(mx, __shfl_xor(mx, 32));
            float sum = 0.f;
#pragma unroll
            for (int kt = 0; kt < 18; ++kt)
#pragma unroll
                for (int i = 0; i < 4; ++i) { const float pe = __expf(s[kt][i] - mx); s[kt][i] = pe; sum += pe; }
            sum += __shfl_xor(sum, 16); sum += __shfl_xor(sum, 32);
            const float inv = 1.0f / (sum + __expf(sink - mx));
            f32x4 o[4];
#pragma unroll
            for (int dt = 0; dt < 4; ++dt) o[dt] = (f32x4){0.f, 0.f, 0.f, 0.f};
#pragma unroll
            for (int pr = 0; pr < 9; ++pr) { const bf16x8 pf = pack8(s[2 * pr], s[2 * pr + 1]);
#pragma unroll
                for (int dt = 0; dt < 4; ++dt) { const LAS bf16_t* vp = Vs + (r0 + 32 * pr + 4 * fq + (fr >> 2)) * AT_KS + 16 * dt + 4 * (fr & 3);
                    o[dt] = __builtin_amdgcn_mfma_f32_16x16x32_bf16(tr_frag(vp, vp + 16 * AT_KS), pf, o[dt], 0, 0, 0); } }
            bf16_t* op = AO + (tokbase + nb * 128 + r0 + fr) * DM + hq * 64 + 4 * fq;
#pragma unroll
            for (int dt = 0; dt < 4; ++dt) { u32x2 w; w.x = pk_bf16(o[dt][0] * inv, o[dt][1] * inv); w.y = pk_bf16(o[dt][2] * inv, o[dt][3] * inv); *(u32x2*)(op + 16 * dt) = w; }
        }
        __syncthreads();
    }
}

constexpr int NPHASES = 1 + DEPTH * 11;
__global__ void __launch_bounds__(NTHREADS, 2) mega_fwd(Args a) {
    extern __shared__ __attribute__((aligned(16))) unsigned char lds_raw[];
    LAS unsigned char* lds = (LAS unsigned char*)lds_raw;
    const int tid0 = threadIdx.x;
    LAS unsigned long long* tabw = (LAS unsigned long long*)(lds + LDS_BYTES - 256);
    if (tid0 == 0) { tabw[0] = (unsigned long long)a.in[0]; tabw[1] = (unsigned long long)a.in[1]; tabw[2] = (unsigned long long)a.in[2]; tabw[3] = (unsigned long long)a.in[3];
        tabw[4] = (unsigned long long)a.in[4]; tabw[5] = (unsigned long long)a.in[5]; tabw[6] = (unsigned long long)a.in[6]; tabw[7] = (unsigned long long)a.in[7];
        tabw[8] = (unsigned long long)a.in[8]; tabw[9] = (unsigned long long)a.in[9]; tabw[10] = (unsigned long long)a.in[10]; tabw[11] = (unsigned long long)a.in[11];
        tabw[12] = (unsigned long long)a.out; tabw[13] = (unsigned long long)a.ws; }
    const int ph_lo = a.ph_lo, ph_hi = a.ph_hi;
    __syncthreads();
    PTab tab = (PTab)tabw;
    for (int ph = ph_lo; ph < ph_hi; ++ph) {
        int tid = threadIdx.x; asm volatile("" : "+v"(tid)); int bid_ = blockIdx.x; asm volatile("" : "+s"(bid_)); int nblk_ = gridDim.x; asm volatile("" : "+s"(nblk_));
        const int lane = tid & 63, wave = __builtin_amdgcn_readfirstlane(tid >> 6);
        unsigned char* ws = (unsigned char*)ldp_u(tab, 13);
        float* Y = (float*)(ws + WS_Y); bf16_t* XB = (bf16_t*)(ws + WS_XB); bf16_t* H = (bf16_t*)(ws + WS_H); bf16_t* P = (bf16_t*)(ws + WS_P);
        float* GATES = (float*)(ws + WS_GATES); float* HF = (float*)(ws + WS_HF); float* HBk = (float*)(ws + WS_HB); bf16_t* AO = (bf16_t*)(ws + WS_AO);
        float* X = (float*)ldp_u(tab, 12);
        if (ph == 0) phase_prologue(tab, lds, wave, lane, bid_, nblk_);
        else {
            const int l = (ph - 1) / 11, s = (ph - 1) % 11, j = l >> 1; const bool is_ml = (l & 1) == 0;
            if (s == 0 || s == 8) {
                const int mi = l * 2 + (s == 8);
                pg8::Gemm g{XB, (const bf16_t*)(ws + WS_WFIN + mi * SZ_WFIN), M_TOK, FF2, DM}; pg8::StaticOrder S; S.init(M_TOK, FF2, nblk_, bid_);
                pg8::EpiSwiGLU E{H, FF};
                pg8::gemm_phase<pg8::EpiSwiGLU, pg8::StaticOrder, true, true>(lds, g, S, E, tid);
            } else if (s == 1 || s == 9) {
                const int mi = l * 2 + (s == 9);
                pg8::Gemm g{H, (const bf16_t*)(ws + WS_WFOUT + mi * SZ_WFOUT), M_TOK, DM, FF}; pg8::StaticOrder S; S.init(M_TOK, DM, nblk_, bid_);
                pg8::EpiResid E{(ph == 2) ? ldp_f(tab, 0) : X, Y, ALPHA, 0.5f};
                pg8::gemm_phase<pg8::EpiResid, pg8::StaticOrder, true, true>(lds, g, S, E, tid);
            } else if (s == 2 || s == 7 || s == 10) {
                const int li = l * 3 + (s == 2 ? 0 : (s == 7 ? 1 : 2));
                phase_ln(Y, ldp_f(tab, 3) + li * DM, ldp_f(tab, 4) + li * DM, X, XB, wave, lane, bid_, nblk_);
            } else if (s == 3) {
                if (is_ml) {
                    const bf16_t* W = (const bf16_t*)(ws + WS_MLIN + j * SZ_MLIN);
                    pg8::Gemm g{XB, W, M_TOK, ML_NG, DM}; pg8::StaticOrder S; S.init(M_TOK, ML_NG, nblk_, bid_);
                    pg8::EpiPlain E{P, ML_NG};
                    pg8::gemm_phase<pg8::EpiPlain, pg8::StaticOrder, true, true>(lds, g, S, E, tid);
                    phase_gates(XB, W + (size_t)ML_NG * DM, ldp_f(tab, 6) + j * 16, GATES, wave, lane, bid_, nblk_);
                } else {
                    pg8::Gemm g{XB, (const bf16_t*)(ws + WS_ATIN + j * SZ_ATIN), M_TOK, AT_N, DM}; pg8::StaticOrder S; S.init(M_TOK, AT_N, nblk_, bid_);
                    pg8::EpiPlain E{P, AT_N};
                    pg8::gemm_phase<pg8::EpiPlain, pg8::StaticOrder, true, true>(lds, g, S, E, tid);
                }
            } else if (s == 4) {
                if (is_ml) phase_mlstm(lds, P, GATES, HF, HBk, tid, wave, lane, bid_, nblk_);
                else phase_attn(lds, P, ldp_f(tab, 10) + j * 16, AO, tid, wave, lane, bid_, nblk_);
            } else if (s == 5) {
                if (is_ml) phase_headnorm(HF, HBk, P, ldp_f(tab, 7) + j * DM, AO, wave, lane, bid_, nblk_);
            } else if (s == 6) {
                pg8::Gemm g{AO, (const bf16_t*)(ws + (is_ml ? WS_MLOUT : WS_ATOUT) + j * SZ_SQ), M_TOK, DM, DM}; pg8::StaticOrder S; S.init(M_TOK, DM, nblk_, bid_);
                pg8::EpiResid E{X, Y, ALPHA, 1.0f};
                pg8::gemm_phase<pg8::EpiResid, pg8::StaticOrder, true, true>(lds, g, S, E, tid);
            }
        }
        if (ph + 1 < ph_hi) { __syncthreads(); cg::this_grid().sync(); }
    }
}

#ifndef MK_PER_PHASE
#define MK_PER_PHASE 1
#endif
extern "C" void kernel_launch(void* const* d_in, const int* in_sizes, int n_in, void* d_out, int out_size, void* d_ws, size_t ws_size, hipStream_t stream) {
    static int grid = 0;
    if (grid == 0) {
        if (n_in != 12 || out_size != M_TOK * DM || ws_size < WS_END) { fprintf(stderr, "kernel_launch: unexpected shapes (n_in %d, out %d, ws %zu < %zu)\n", n_in, out_size, ws_size, (size_t)WS_END); grid = -1; return; }
        int dev = 0, cus = 0, per_cu = 0;
        hipGetDevice(&dev); hipDeviceGetAttribute(&cus, hipDeviceAttributeMultiprocessorCount, dev);
        if (hipFuncSetAttribute((const void*)mega_fwd, hipFuncAttributeMaxDynamicSharedMemorySize, LDS_BYTES) != hipSuccess) { fprintf(stderr, "kernel_launch: hipFuncSetAttribute failed\n"); grid = -1; return; }
        hipOccupancyMaxActiveBlocksPerMultiprocessor(&per_cu, (const void*)mega_fwd, NTHREADS, LDS_BYTES);
        if (per_cu < 1) { fprintf(stderr, "kernel_launch: occupancy query says %d blocks per CU\n", per_cu); per_cu = 1; }
        (void)hipGetLastError();
        grid = cus;
    }
    if (grid < 0) return;
    Args a{};
    for (int i = 0; i < 12; ++i) a.in[i] = (const float*)d_in[i];
    a.out = (float*)d_out; a.ws = (unsigned char*)d_ws;
#if MK_PER_PHASE
    for (int ph = 0; ph < NPHASES; ++ph) {
        const int s = ph ? (ph - 1) % 11 : -1, l = ph ? (ph - 1) / 11 : 0;
        if (s == 5 && (l & 1) == 1) continue;
        a.ph_lo = ph; a.ph_hi = ph + 1;
        hipLaunchKernelGGL(mega_fwd, dim3(grid), dim3(NTHREADS), LDS_BYTES, stream, a);
    }
#else
    a.ph_lo = 0; a.ph_hi = NPHASES;
    void* args[] = {&a};
    hipError_t e = hipLaunchCooperativeKernel((const void*)mega_fwd, dim3(grid), dim3(NTHREADS), args, LDS_BYTES, stream);
    if (e != hipSuccess) fprintf(stderr, "cooperative launch failed: %s (grid %d)\n", hipGetErrorString(e), grid);
#endif
}
```
